# Optimizing an MI355X kernel written in HIP

```python
import math
import jax, jax.numpy as jnp
from jax import lax
import numpy as np

D_MODEL = 1024
BATCH = 4
SEQ = 4096
DEPTH = 4
DEC_BATCH = 128
DEC_SEQ = 8
PAST_LEN = 8192
PAGE_SIZE = 128

N_MIXERS = 2
N_ATTN_LAYERS = (DEPTH + 1) // 2
N_RWKV_LAYERS = DEPTH // 2
HEAD_DIM = 64
N_HEADS = D_MODEL // HEAD_DIM
N_KV_HEADS = 4
GROUP = N_HEADS // N_KV_HEADS
WINDOW = 128
BLOCK = WINDOW
N_BUCKETS = 32
MAX_DISTANCE = 128
RWKV_HEAD = 64
RWKV_HEADS = D_MODEL // RWKV_HEAD
LORA_DECAY = 64
LORA_AAA = 64
LORA_MV = 32
LORA_GATE = 160
GN_EPS = 64e-5
D_FF = -(-8 * D_MODEL // (3 * 256)) * 256
ALPHA = (2 * DEPTH) ** 0.25
BETA = (8 * DEPTH) ** -0.25
LN_EPS = 1e-5

kernel_name = 'hybrid_swa_sink_rwkv7_deepnorm_step'


def layer_norm(x, g, b):
    xf = x.astype(jnp.float32)
    mu = xf.mean(-1, keepdims=True)
    var = jnp.square(xf - mu).mean(-1, keepdims=True)
    return ((xf - mu) * lax.rsqrt(var + LN_EPS) * g + b).astype(x.dtype)


def t5_bucket(d):
    d = jnp.maximum(d, 0)
    exact = N_BUCKETS // 2
    df = jnp.maximum(d, 1).astype(jnp.float32)
    large = exact + (jnp.log(df / exact) / math.log(MAX_DISTANCE / exact)
                     * (N_BUCKETS - exact)).astype(jnp.int32)
    return jnp.where(d < exact, d, jnp.minimum(large, N_BUCKETS - 1))


def rel_bias_for(d, rel_bias):
    b = rel_bias[t5_bucket(d)]
    return jnp.moveaxis(b, -1, 0).reshape((N_KV_HEADS, GROUP) + d.shape)


def sink_attention(q, k, v, d, valid, sinks, rel_bias):
    s = jnp.einsum('...qkgd,...skd->...kgqs', q, k).astype(jnp.float32) * HEAD_DIM ** -0.5
    s = s + rel_bias_for(d, rel_bias).astype(jnp.float32)
    s = jnp.where(valid, s, -jnp.inf)
    sink = jnp.broadcast_to(sinks.astype(jnp.float32).reshape(N_KV_HEADS, GROUP, 1, 1),
                            s.shape[:-1] + (1,))
    p = jax.nn.softmax(jnp.concatenate([s, sink], axis=-1), axis=-1)[..., :-1]
    return jnp.einsum('...kgqs,...skd->...qkgd', p.astype(v.dtype), v)


def qkv_proj(x, w_qkv, b_qkv):
    lead = x.shape[:-1]
    qkv = x @ w_qkv + b_qkv
    nq, nk = N_HEADS * HEAD_DIM, N_KV_HEADS * HEAD_DIM
    q = qkv[..., :nq].reshape(lead + (N_KV_HEADS, GROUP, HEAD_DIM))
    k = qkv[..., nq:nq + nk].reshape(lead + (N_KV_HEADS, HEAD_DIM))
    v = qkv[..., nq + nk:].reshape(lead + (N_KV_HEADS, HEAD_DIM))
    return q, k, v


def swa_prompt(x, w_qkv, b_qkv, w_o, b_o, sinks, rel_bias):
    B, T, _ = x.shape
    nb = T // BLOCK
    q, k, v = qkv_proj(x, w_qkv, b_qkv)

    def band(t):
        prev = jnp.pad(t[:, :T - BLOCK], ((0, 0), (BLOCK, 0), (0, 0), (0, 0)))
        return jnp.concatenate([prev.reshape(B, nb, BLOCK, N_KV_HEADS, HEAD_DIM),
                                t.reshape(B, nb, BLOCK, N_KV_HEADS, HEAD_DIM)], axis=2)

    qi = jnp.arange(BLOCK)[:, None]
    sj = jnp.arange(2 * BLOCK)[None, :]
    d = qi + BLOCK - sj
    blk = jnp.arange(nb)[:, None, None]
    valid = (d >= 0) & (d < WINDOW) & (blk * BLOCK + sj - BLOCK >= 0)
    o = sink_attention(q.reshape(B, nb, BLOCK, N_KV_HEADS, GROUP, HEAD_DIM), band(k), band(v),
                       d, valid[:, None, None], sinks, rel_bias)
    y = o.reshape(B, T, N_HEADS * HEAD_DIM) @ w_o + b_o
    return y, k[:, T - WINDOW:], v[:, T - WINDOW:]


def swa_sample(x, ck, cv, w_qkv, b_qkv, w_o, b_o, sinks, rel_bias):
    B, T, _ = x.shape
    L = ck.shape[1]
    q, k, v = qkv_proj(x, w_qkv, b_qkv)
    keys = jnp.concatenate([ck, k.astype(ck.dtype)], axis=1)
    vals = jnp.concatenate([cv, v.astype(cv.dtype)], axis=1)
    d = jnp.arange(T)[:, None] + L - jnp.arange(L + T)[None, :]
    valid = (d >= 0) & (d < WINDOW)
    o = sink_attention(q, keys, vals, d, valid, sinks, rel_bias)
    y = o.reshape(B, T, N_HEADS * HEAD_DIM) @ w_o + b_o
    return y, keys[:, T:], vals[:, T:]


def rwkv7_time_mix(x, x_prev, s0, v_first, mix, w_rkv, w0, w1, w2, a0, a1, a2,
                   g1, g2, k_k, k_a, r_k, ln_w, ln_b, w_o, vres):
    B, T, D = x.shape
    xx = jnp.concatenate([x_prev[:, None].astype(x.dtype), x[:, :-1]], axis=1) - x
    xr, xw, xk, xv, xa, xg = (x + xx * mix[c] for c in range(6))
    r = xr @ w_rkv[0]
    k = xk @ w_rkv[1]
    v = xv @ w_rkv[2]
    w = -jax.nn.softplus(-(w0 + jnp.tanh(xw @ w1) @ w2)) - 0.5
    if vres is None:
        v_first = v
    else:
        v0, v1, v2 = vres
        v = v + (v_first - v) * jax.nn.sigmoid(v0 + (xv @ v1) @ v2)
    a = jax.nn.sigmoid(a0 + (xa @ a1) @ a2)
    g = jax.nn.sigmoid(xg @ g1) @ g2

    def heads(t):
        return t.reshape(B, T, RWKV_HEADS, RWKV_HEAD).astype(jnp.float32)

    kk = heads(k * k_k)
    kk = kk / jnp.maximum(jnp.sqrt(jnp.sum(kk * kk, axis=-1, keepdims=True)), 1e-12)
    k = k * (1 + (a - 1) * k_a)
    rh, kh, vh, ah = heads(r), heads(k), heads(v), heads(a)
    decay = jnp.exp(-jnp.exp(heads(w)))

    def step(S, inp):
        r_t, d_t, k_t, v_t, kk_t, a_t = inp
        sa = jnp.einsum('bhvk,bhk->bhv', S, -kk_t)
        S = (S * d_t[:, :, None, :] + sa[..., None] * (kk_t * a_t)[:, :, None, :]
             + v_t[..., None] * k_t[:, :, None, :])
        return S, jnp.einsum('bhvk,bhk->bhv', S, r_t)

    seq = tuple(jnp.moveaxis(t, 1, 0) for t in (rh, decay, kh, vh, kk, ah))
    S, o = lax.scan(step, s0.astype(jnp.float32), seq)
    o = jnp.moveaxis(o, 0, 1)
    mu = o.mean(-1, keepdims=True)
    var = jnp.square(o - mu).mean(-1, keepdims=True)
    o = ((o - mu) * lax.rsqrt(var + GN_EPS)).reshape(B, T, D) * ln_w + ln_b
    bonus = (jnp.sum(rh * kh * r_k.astype(jnp.float32), axis=-1, keepdims=True) * vh).reshape(B, T, D)
    y = ((o + bonus) * g).astype(x.dtype) @ w_o
    return y, v_first, S.astype(s0.dtype), x[:, -1]


def swiglu(x, w_gu, w_down):
    gu = x @ w_gu
    return (jax.nn.silu(gu[..., :D_FF]) * gu[..., D_FF:]) @ w_down


def trunk(x, win_k, win_v, shift, wkv, P):
    prompt = win_k is None
    B = x.shape[0]
    v_first = None
    nk, nv, ns, nw = [], [], [], []
    for i in range(DEPTH):
        j = i // N_MIXERS
        if i % N_MIXERS == 0:
            args = (P['attn_w_qkv'][j], P['attn_b_qkv'][j], P['attn_w_o'][j], P['attn_b_o'][j],
                    P['attn_sinks'][j], P['rel_bias'])
            if prompt:
                h, k_buf, v_buf = swa_prompt(x, *args)
            else:
                h, k_buf, v_buf = swa_sample(x, win_k[j], win_v[j], *args)
            nk.append(k_buf)
            nv.append(v_buf)
        else:
            if prompt:
                x_prev = jnp.zeros((B, D_MODEL), x.dtype)
                s0 = jnp.zeros((B, RWKV_HEADS, RWKV_HEAD, RWKV_HEAD), x.dtype)
            else:
                x_prev, s0 = shift[j], wkv[j]
            vres = None if j == 0 else (P['rwkv_v0'][j - 1], P['rwkv_v1'][j - 1], P['rwkv_v2'][j - 1])
            h, v_first, s_new, last = rwkv7_time_mix(
                x, x_prev, s0, v_first, P['rwkv_mix'][j], P['rwkv_w_rkv'][j],
                P['rwkv_w0'][j], P['rwkv_w1'][j], P['rwkv_w2'][j],
                P['rwkv_a0'][j], P['rwkv_a1'][j], P['rwkv_a2'][j],
                P['rwkv_g1'][j], P['rwkv_g2'][j], P['rwkv_k_k'][j], P['rwkv_k_a'][j],
                P['rwkv_r_k'][j], P['rwkv_ln_w'][j], P['rwkv_ln_b'][j], P['rwkv_w_o'][j], vres)
            ns.append(last)
            nw.append(s_new)
        x = layer_norm(ALPHA * x + h, P['ln_g'][i, 0], P['ln_b'][i, 0])
        x = layer_norm(ALPHA * x + swiglu(x, P['ffn_w_gu'][i], P['ffn_w_down'][i]),
                       P['ln_g'][i, 1], P['ln_b'][i, 1])
    return x, jnp.stack(nk), jnp.stack(nv), jnp.stack(ns), jnp.stack(nw)


def setup_inputs(seed: int = 0) -> dict:
    key = jax.random.key(seed)
    keys = jax.random.split(key, 48)
    it = (keys[i] for i in range(48))

    def nrm(shape, scale):
        return scale * jax.random.normal(next(it), shape, jnp.float32)

    def uni(shape, lo, hi):
        return jax.random.uniform(next(it), shape, jnp.float32, lo, hi)

    NA, NR, D = N_ATTN_LAYERS, N_RWKV_LAYERS, D_MODEL
    QKV = (N_HEADS + 2 * N_KV_HEADS) * HEAD_DIM
    win_rows = min(WINDOW, PAST_LEN)
    return {
        'x_prompt': nrm((BATCH, SEQ, D), 1.0),
        'x_sample': nrm((DEC_BATCH, DEC_SEQ, D), 1.0),
        'cache_win_k': nrm((NA, DEC_BATCH, win_rows, N_KV_HEADS, HEAD_DIM), 1.0),
        'cache_win_v': nrm((NA, DEC_BATCH, win_rows, N_KV_HEADS, HEAD_DIM), 1.0),
        'state_shift': nrm((NR, DEC_BATCH, D), 1.0),
        'state_wkv': nrm((NR, DEC_BATCH, RWKV_HEADS, RWKV_HEAD, RWKV_HEAD), 0.3),
        'rel_bias': nrm((N_BUCKETS, N_HEADS), 0.5),
        'ln_g': 1.0 + nrm((DEPTH, 2, D), 0.05),
        'ln_b': nrm((DEPTH, 2, D), 0.02),
        'attn_w_qkv': nrm((NA, D, QKV), D ** -0.5),
        'attn_b_qkv': nrm((NA, QKV), 0.02),
        'attn_w_o': nrm((NA, N_HEADS * HEAD_DIM, D), BETA * (N_HEADS * HEAD_DIM) ** -0.5),
        'attn_b_o': nrm((NA, D), 0.02),
        'attn_sinks': nrm((NA, N_HEADS), 1.0),
        'rwkv_mix': uni((NR, 6, D), 0.0, 1.0),
        'rwkv_w_rkv': nrm((NR, 3, D, D), D ** -0.5),
        'rwkv_w0': uni((NR, D), -6.0, -1.0),
        'rwkv_w1': nrm((NR, D, LORA_DECAY), D ** -0.5),
        'rwkv_w2': nrm((NR, LORA_DECAY, D), 0.1 * LORA_DECAY ** -0.5),
        'rwkv_a0': nrm((NR, D), 0.1),
        'rwkv_a1': nrm((NR, D, LORA_AAA), D ** -0.5),
        'rwkv_a2': nrm((NR, LORA_AAA, D), LORA_AAA ** -0.5),
        'rwkv_v0': nrm((NR - 1, D), 0.1),
        'rwkv_v1': nrm((NR - 1, D, LORA_MV), D ** -0.5),
        'rwkv_v2': nrm((NR - 1, LORA_MV, D), LORA_MV ** -0.5),
        'rwkv_g1': nrm((NR, D, LORA_GATE), D ** -0.5),
        'rwkv_g2': nrm((NR, LORA_GATE, D), LORA_GATE ** -0.5),
        'rwkv_k_k': 0.85 + nrm((NR, D), 0.05),
        'rwkv_k_a': 1.0 + nrm((NR, D), 0.05),
        'rwkv_r_k': nrm((NR, RWKV_HEADS, RWKV_HEAD), 0.1),
        'rwkv_ln_w': 1.0 + nrm((NR, D), 0.05),
        'rwkv_ln_b': nrm((NR, D), 0.02),
        'rwkv_w_o': nrm((NR, D, D), BETA * D ** -0.5),
        'ffn_w_gu': nrm((DEPTH, D, 2 * D_FF), D ** -0.5),
        'ffn_w_down': nrm((DEPTH, D_FF, D), BETA * D_FF ** -0.5),
    }


def reference(x_prompt, x_sample, cache_win_k, cache_win_v, state_shift, state_wkv,
              rel_bias, ln_g, ln_b, attn_w_qkv, attn_b_qkv, attn_w_o, attn_b_o, attn_sinks,
              rwkv_mix, rwkv_w_rkv, rwkv_w0, rwkv_w1, rwkv_w2, rwkv_a0, rwkv_a1, rwkv_a2,
              rwkv_v0, rwkv_v1, rwkv_v2, rwkv_g1, rwkv_g2, rwkv_k_k, rwkv_k_a, rwkv_r_k,
              rwkv_ln_w, rwkv_ln_b, rwkv_w_o, ffn_w_gu, ffn_w_down):
    P = dict(rel_bias=rel_bias, ln_g=ln_g, ln_b=ln_b,
             attn_w_qkv=attn_w_qkv, attn_b_qkv=attn_b_qkv, attn_w_o=attn_w_o,
             attn_b_o=attn_b_o, attn_sinks=attn_sinks,
             rwkv_mix=rwkv_mix, rwkv_w_rkv=rwkv_w_rkv, rwkv_w0=rwkv_w0, rwkv_w1=rwkv_w1,
             rwkv_w2=rwkv_w2, rwkv_a0=rwkv_a0, rwkv_a1=rwkv_a1, rwkv_a2=rwkv_a2,
             rwkv_v0=rwkv_v0, rwkv_v1=rwkv_v1, rwkv_v2=rwkv_v2, rwkv_g1=rwkv_g1,
             rwkv_g2=rwkv_g2, rwkv_k_k=rwkv_k_k, rwkv_k_a=rwkv_k_a, rwkv_r_k=rwkv_r_k,
             rwkv_ln_w=rwkv_ln_w, rwkv_ln_b=rwkv_ln_b, rwkv_w_o=rwkv_w_o,
             ffn_w_gu=ffn_w_gu, ffn_w_down=ffn_w_down)
    y_prompt, pk, pv, ps, pw = trunk(x_prompt, None, None, None, None, P)
    y_sample, sk, sv, ss, sw = trunk(x_sample, cache_win_k, cache_win_v, state_shift, state_wkv, P)
    return (y_prompt, y_sample, pk, pv, ps, pw, sk, sv, ss, sw)
```

```cpp
#include <hip/hip_runtime.h>
#include <cstdint>
#include <cstdio>

namespace {
constexpr int D = 1024, SEQ = 4096, NB = 4, DB = 128, DT = 8, WIN = 128, KVH = 4, HD = 64, NH = 16;
constexpr int QKV = 1536, DFF = 2816;
constexpr float ALPHA = 1.6817928305074290860622509524664f;
constexpr float LN_EPS = 1e-5f, GN_EPS = 64e-5f;

__constant__ int c_bucket[128] = {0, 1, 2, 3, 4, 5, 6, 7, 8, 9, 10, 11, 12, 13, 14, 15, 16, 16, 16, 17, 17, 18, 18, 18, 19, 19, 19, 20, 20, 20, 20, 21, 21, 21, 21, 22, 22, 22, 22, 22, 23, 23, 23, 23, 23, 23, 24, 24, 24, 24, 24, 24, 25, 25, 25, 25, 25, 25, 25, 26, 26, 26, 26, 26, 26, 26, 26, 27, 27, 27, 27, 27, 27, 27, 27, 27, 27, 28, 28, 28, 28, 28, 28, 28, 28, 28, 28, 29, 29, 29, 29, 29, 29, 29, 29, 29, 29, 29, 29, 30, 30, 30, 30, 30, 30, 30, 30, 30, 30, 30, 30, 30, 30, 31, 31, 31, 31, 31, 31, 31, 31, 31, 31, 31, 31, 31, 31, 31};

__device__ __forceinline__ float wave_sum(float v) {
#pragma unroll
    for (int o = 32; o > 0; o >>= 1) v += __shfl_xor(v, o);
    return v;
}
__device__ __forceinline__ float wave_max(float v) {
#pragma unroll
    for (int o = 32; o > 0; o >>= 1) v = fmaxf(v, __shfl_xor(v, o));
    return v;
}
__device__ __forceinline__ float sigmoidf_(float x) { return 1.0f / (1.0f + expf(-x)); }

template <int DUAL>
__global__ void __launch_bounds__(256) gemm_naive(const float* __restrict__ A, int lda, const float* __restrict__ W, int ldw, int K, int N,
                                                  float* __restrict__ C, int ldc, const float* __restrict__ bias, int act, int dual_off) {
    __shared__ float As[16][64 + 4];
    __shared__ float Bs[16][64 + 4];
    __shared__ float Bs2[DUAL ? 16 : 1][64 + 4];
    const int tid = threadIdx.x, tx = tid & 15, ty = tid >> 4;
    const int m0 = blockIdx.y * 64, n0 = blockIdx.x * 64;
    float acc[4][4] = {}, acc2[4][4] = {};
    const int ar = tid >> 2, ak = (tid & 3) * 4;
    const int bk = tid >> 4, bn = (tid & 15) * 4;
    for (int k0 = 0; k0 < K; k0 += 16) {
        const float4 av = *(const float4*)(A + (size_t)(m0 + ar) * lda + k0 + ak);
        As[ak + 0][ar] = av.x; As[ak + 1][ar] = av.y; As[ak + 2][ar] = av.z; As[ak + 3][ar] = av.w;
        float4 bv = make_float4(0.f, 0.f, 0.f, 0.f);
        if (n0 + bn < N) bv = *(const float4*)(W + (size_t)(k0 + bk) * ldw + n0 + bn);
        Bs[bk][bn] = bv.x; Bs[bk][bn + 1] = bv.y; Bs[bk][bn + 2] = bv.z; Bs[bk][bn + 3] = bv.w;
        if (DUAL) {
            float4 cv = make_float4(0.f, 0.f, 0.f, 0.f);
            if (n0 + bn < N) cv = *(const float4*)(W + (size_t)(k0 + bk) * ldw + dual_off + n0 + bn);
            Bs2[bk][bn] = cv.x; Bs2[bk][bn + 1] = cv.y; Bs2[bk][bn + 2] = cv.z; Bs2[bk][bn + 3] = cv.w;
        }
        __syncthreads();
#pragma unroll
        for (int k = 0; k < 16; ++k) {
            float a[4], b[4], b2[4];
#pragma unroll
            for (int i = 0; i < 4; ++i) { a[i] = As[k][ty * 4 + i]; b[i] = Bs[k][tx * 4 + i]; b2[i] = DUAL ? Bs2[k][tx * 4 + i] : 0.f; }
#pragma unroll
            for (int i = 0; i < 4; ++i)
#pragma unroll
                for (int j = 0; j < 4; ++j) { acc[i][j] = fmaf(a[i], b[j], acc[i][j]); if (DUAL) acc2[i][j] = fmaf(a[i], b2[j], acc2[i][j]); }
        }
        __syncthreads();
    }
#pragma unroll
    for (int i = 0; i < 4; ++i)
#pragma unroll
        for (int j = 0; j < 4; ++j) {
            const int r = m0 + ty * 4 + i, c = n0 + tx * 4 + j;
            if (c < N) {
                float v = acc[i][j];
                if (DUAL) { v = v * sigmoidf_(v) * acc2[i][j]; }
                else {
                    if (bias) v += bias[c];
                    if (act == 1) v = tanhf(v); else if (act == 2) v = sigmoidf_(v);
                }
                C[(size_t)r * ldc + c] = v;
            }
        }
}

__global__ void __launch_bounds__(256) ln_res(const float* x, const float* __restrict__ h, const float* __restrict__ g, const float* __restrict__ b, float* out) {
    __shared__ float red[8];
    const int row = blockIdx.x, tid = threadIdx.x;
    const float4 xv = *(const float4*)(x + (size_t)row * D + tid * 4), hv = *(const float4*)(h + (size_t)row * D + tid * 4);
    float v[4] = {ALPHA * xv.x + hv.x, ALPHA * xv.y + hv.y, ALPHA * xv.z + hv.z, ALPHA * xv.w + hv.w};
    float s = wave_sum(v[0] + v[1] + v[2] + v[3]);
    if ((tid & 63) == 0) red[tid >> 6] = s;
    __syncthreads();
    const float mean = (red[0] + red[1] + red[2] + red[3]) * (1.0f / D);
    float q = 0.f;
#pragma unroll
    for (int i = 0; i < 4; ++i) { const float d = v[i] - mean; q += d * d; }
    q = wave_sum(q);
    if ((tid & 63) == 0) red[4 + (tid >> 6)] = q;
    __syncthreads();
    const float var = (red[4] + red[5] + red[6] + red[7]) * (1.0f / D);
    const float rstd = 1.0f / sqrtf(var + LN_EPS);
    const float4 gv = *(const float4*)(g + tid * 4), bv = *(const float4*)(b + tid * 4);
    float4 o;
    o.x = (v[0] - mean) * rstd * gv.x + bv.x; o.y = (v[1] - mean) * rstd * gv.y + bv.y;
    o.z = (v[2] - mean) * rstd * gv.z + bv.z; o.w = (v[3] - mean) * rstd * gv.w + bv.w;
    *(float4*)(out + (size_t)row * D + tid * 4) = o;
}

__global__ void __launch_bounds__(256) attn_naive(const float* __restrict__ qkv, int T, int sample, const float* __restrict__ ck, const float* __restrict__ cv,
                                                  const float* __restrict__ sinks, const float* __restrict__ rel_bias, float* __restrict__ o, int Mc) {
    const int wave = (blockIdx.x * 256 + threadIdx.x) >> 6, lane = threadIdx.x & 63;
    if (wave >= Mc * NH) return;
    const int row = wave / NH, h = wave % NH, kvh = h / 4;
    const int b = row / T, t = row % T;
    const float q = qkv[(size_t)row * QKV + h * HD + lane];
    float sc[2]; bool valid[2];
    const float* kp[2];
#pragma unroll
    for (int u = 0; u < 2; ++u) {
        const int jj = lane + 64 * u;
        if (!sample) { const int kt = t - 127 + jj; valid[u] = kt >= 0; kp[u] = qkv + (size_t)(b * T + (valid[u] ? kt : 0)) * QKV + D + kvh * HD; }
        else { const int s = t + 1 + jj; valid[u] = true; kp[u] = (s < WIN) ? ck + ((size_t)(b * WIN + s) * KVH + kvh) * HD : qkv + (size_t)(b * T + (s - WIN)) * QKV + D + kvh * HD; }
        sc[u] = 0.f;
    }
    for (int d = 0; d < HD; ++d) {
        const float qd = __shfl(q, d);
        sc[0] = fmaf(qd, kp[0][d], sc[0]); sc[1] = fmaf(qd, kp[1][d], sc[1]);
    }
    const float sink = sinks[h];
    float m = sink;
#pragma unroll
    for (int u = 0; u < 2; ++u) {
        const int dd = 127 - (lane + 64 * u);
        sc[u] = sc[u] * 0.125f + rel_bias[c_bucket[dd] * NH + h];
        if (!valid[u]) sc[u] = -INFINITY;
        m = fmaxf(m, sc[u]);
    }
    m = wave_max(m);
    float e[2]; e[0] = valid[0] ? expf(sc[0] - m) : 0.f; e[1] = valid[1] ? expf(sc[1] - m) : 0.f;
    const float denom = wave_sum(e[0] + e[1]) + expf(sink - m);
    const float inv = 1.0f / denom;
    float acc = 0.f;
    for (int jj = 0; jj < 128; ++jj) {
        const float p = __shfl(jj < 64 ? e[0] : e[1], jj & 63);
        if (p != 0.f) {
            const float* vp;
            if (!sample) { const int kt = t - 127 + jj; vp = qkv + (size_t)(b * T + kt) * QKV + D + 256 + kvh * HD; }
            else { const int s = t + 1 + jj; vp = (s < WIN) ? cv + ((size_t)(b * WIN + s) * KVH + kvh) * HD : qkv + (size_t)(b * T + (s - WIN)) * QKV + D + 256 + kvh * HD; }
            acc = fmaf(p, vp[lane], acc);
        }
    }
    o[(size_t)row * D + h * HD + lane] = acc * inv;
}

__global__ void cache_out(const float* __restrict__ qkv, int T, int sample, const float* __restrict__ cache, int off, float* __restrict__ out, int nseq) {
    const size_t i = (size_t)blockIdx.x * 256 + threadIdx.x;
    if (i >= (size_t)nseq * WIN * 256) return;
    const int c = i % 256, w = (i / 256) % WIN, b = i / (256 * WIN);
    float v;
    if (!sample) v = qkv[(size_t)(b * T + T - WIN + w) * QKV + off + c];
    else v = (w < WIN - DT) ? cache[((size_t)b * WIN + w + DT) * 256 + c] : qkv[(size_t)(b * T + w - (WIN - DT)) * QKV + off + c];
    out[i] = v;
}

__global__ void __launch_bounds__(256) rwkv_mix(const float* __restrict__ x, int T, const float* __restrict__ shift  , const float* __restrict__ mix, float* __restrict__ out, size_t cstride, float* __restrict__ new_shift) {
    const int row = blockIdx.x, tid = threadIdx.x, b = row / T, t = row % T;
    for (int i = tid; i < D; i += 256) {
        const float xv = x[(size_t)row * D + i];
        const float xp = t > 0 ? x[(size_t)(row - 1) * D + i] : (shift ? shift[(size_t)b * D + i] : 0.f);
        const float xx = xp - xv;
#pragma unroll
        for (int c = 0; c < 6; ++c) out[c * cstride + (size_t)row * D + i] = xv + xx * mix[c * D + i];
        if (t == T - 1) new_shift[(size_t)b * D + i] = xv;
    }
}

__global__ void __launch_bounds__(256) rwkv_prep(float* __restrict__ k, float* __restrict__ v, float* __restrict__ wl, float* __restrict__ al, const float* __restrict__ vl,
                                                 float* __restrict__ kk, float* __restrict__ vfirst, int first_layer,
                                                 const float* __restrict__ w0, const float* __restrict__ a0, const float* __restrict__ v0, const float* __restrict__ k_k, const float* __restrict__ k_a, int Mc) {
    const int wave = (blockIdx.x * 256 + threadIdx.x) >> 6, lane = threadIdx.x & 63;
    if (wave >= Mc * 16) return;
    const int row = wave / 16, h = wave % 16, c = h * 64 + lane;
    const size_t i = (size_t)row * D + c;
    const float wpre = w0[c] + wl[i];
    const float nx = -wpre;
    const float sp = fmaxf(nx, 0.f) + log1pf(expf(-fabsf(nx)));
    const float w = -sp - 0.5f;
    const float dec = expf(-expf(w));
    const float a = sigmoidf_(a0[c] + al[i]);
    float vv = v[i];
    if (first_layer) vfirst[i] = vv; else vv = vv + (vfirst[i] - vv) * sigmoidf_(v0[c] + vl[i]);
    const float kv = k[i];
    const float kr = kv * k_k[c];
    const float nrm = sqrtf(wave_sum(kr * kr));
    const float kkn = kr / fmaxf(nrm, 1e-12f);
    wl[i] = dec; al[i] = kkn * a; kk[i] = kkn; k[i] = kv * (1.0f + (a - 1.0f) * k_a[c]); v[i] = vv;
}

__global__ void __launch_bounds__(256) rwkv_scan(const float* __restrict__ r, const float* __restrict__ dec, const float* __restrict__ k, const float* __restrict__ v, const float* __restrict__ kk, const float* __restrict__ ka,
                                                 int T, const float* __restrict__ s0  , float* __restrict__ o, float* __restrict__ s_out) {
    const int b = blockIdx.x / 16, h = blockIdx.x % 16, tid = threadIdx.x, vr = tid >> 2, ks = tid & 3;
    float S[16];
    const size_t sbase = ((size_t)(b * 16 + h) * 64 + vr) * 64 + ks * 16;
#pragma unroll
    for (int i = 0; i < 16; ++i) S[i] = s0 ? s0[sbase + i] : 0.f;
    for (int t = 0; t < T; ++t) {
        const size_t base = (size_t)(b * T + t) * D + h * 64;
        const float* rp = r + base + ks * 16; const float* dp = dec + base + ks * 16; const float* kp = k + base + ks * 16;
        const float* kkp = kk + base + ks * 16; const float* kap = ka + base + ks * 16;
        const float vv = v[base + vr];
        float sa = 0.f;
#pragma unroll
        for (int i = 0; i < 16; ++i) sa = fmaf(S[i], -kkp[i], sa);
        sa += __shfl_xor(sa, 1); sa += __shfl_xor(sa, 2);
        float ov = 0.f;
#pragma unroll
        for (int i = 0; i < 16; ++i) { S[i] = S[i] * dp[i] + sa * kap[i] + vv * kp[i]; ov = fmaf(S[i], rp[i], ov); }
        ov += __shfl_xor(ov, 1); ov += __shfl_xor(ov, 2);
        if (ks == 0) o[base + vr] = ov;
    }
#pragma unroll
    for (int i = 0; i < 16; ++i) s_out[sbase + i] = S[i];
}

__global__ void __launch_bounds__(256) rwkv_post(const float* __restrict__ o, const float* __restrict__ r, const float* __restrict__ k, const float* __restrict__ v, const float* __restrict__ g,
                                                 const float* __restrict__ r_k, const float* __restrict__ ln_w, const float* __restrict__ ln_b, float* __restrict__ yin, int Mc) {
    const int wave = (blockIdx.x * 256 + threadIdx.x) >> 6, lane = threadIdx.x & 63;
    if (wave >= Mc * 16) return;
    const int row = wave / 16, h = wave % 16, c = h * 64 + lane;
    const size_t i = (size_t)row * D + c;
    const float ov = o[i];
    const float mu = wave_sum(ov) * (1.0f / 64.0f);
    const float dv = ov - mu;
    const float var = wave_sum(dv * dv) * (1.0f / 64.0f);
    const float on = dv * (1.0f / sqrtf(var + GN_EPS)) * ln_w[c] + ln_b[c];
    const float bonus = wave_sum(r[i] * k[i] * r_k[c]) * v[i];
    yin[i] = (on + bonus) * g[i];
}

__global__ void copy_f32(const float* __restrict__ src, float* __restrict__ dst, size_t n) {
    const size_t i = (size_t)blockIdx.x * 256 + threadIdx.x; if (i < n) dst[i] = src[i];
}

struct Bump { float* p; size_t used; float* take(size_t n) { float* r = p + used; used += (n + 63) & ~(size_t)63; return r; } };

void gemm(hipStream_t st, const float* A, int lda, const float* W, int ldw, int M, int K, int N, float* C, int ldc, const float* bias, int act) {
    dim3 grid((N + 63) / 64, M / 64);
    hipLaunchKernelGGL(gemm_naive<0>, grid, dim3(256), 0, st, A, lda, W, ldw, K, N, C, ldc, bias, act, 0);
}
}

extern "C" void kernel_launch(void* const* d_in, const int* in_sizes, int n_in, void* d_out, int out_size, void* d_ws, size_t ws_size, hipStream_t stream) {
    const float* x_prompt = (const float*)d_in[0]; const float* x_sample = (const float*)d_in[1];
    const float* cache_k = (const float*)d_in[2]; const float* cache_v = (const float*)d_in[3];
    const float* state_shift = (const float*)d_in[4]; const float* state_wkv = (const float*)d_in[5];
    const float* rel_bias = (const float*)d_in[6]; const float* ln_g = (const float*)d_in[7]; const float* ln_b = (const float*)d_in[8];
    const float* w_qkv = (const float*)d_in[9]; const float* b_qkv = (const float*)d_in[10]; const float* w_o = (const float*)d_in[11]; const float* b_o = (const float*)d_in[12];
    const float* sinks = (const float*)d_in[13]; const float* mix = (const float*)d_in[14]; const float* w_rkv = (const float*)d_in[15];
    const float* w0 = (const float*)d_in[16]; const float* w1 = (const float*)d_in[17]; const float* w2 = (const float*)d_in[18];
    const float* a0 = (const float*)d_in[19]; const float* a1 = (const float*)d_in[20]; const float* a2 = (const float*)d_in[21];
    const float* v0 = (const float*)d_in[22]; const float* v1 = (const float*)d_in[23]; const float* v2 = (const float*)d_in[24];
    const float* g1 = (const float*)d_in[25]; const float* g2 = (const float*)d_in[26]; const float* k_k = (const float*)d_in[27]; const float* k_a = (const float*)d_in[28];
    const float* r_k = (const float*)d_in[29]; const float* gn_w = (const float*)d_in[30]; const float* gn_b = (const float*)d_in[31]; const float* rw_o = (const float*)d_in[32];
    const float* w_gu = (const float*)d_in[33]; const float* w_down = (const float*)d_in[34];
    float* out = (float*)d_out;
    float* o_yp = out; float* o_ys = out + 16777216; float* o_pk = out + 17825792; float* o_pv = out + 18087936; float* o_ps = out + 18350080; float* o_pw = out + 18358272;
    float* o_sk = out + 18882560; float* o_sv = out + 27271168; float* o_ss = out + 35659776; float* o_sw = out + 35921920;
    if (ws_size < (size_t)448 * 1024 * 1024) return;

    const size_t U = (size_t)4096 * D;
    Bump bp{(float*)d_ws, 0};
    float* xc = bp.take(U); float* hb = bp.take(U); float* vfirst = bp.take(U);
    float* R = bp.take(14 * U);
    float* qkv = R; float* ao = R + (size_t)4096 * QKV;
    float* act = R;
    float* mix6 = R; float* rr = R + 6 * U; float* kb = rr + U; float* vb = kb + U; float* wl = vb + U; float* al = wl + U; float* vl = al + U; float* gb = vl + U; float* kkb = gb + U;
    float* lw = kkb + U; float* la = lw + (size_t)4096 * 64; float* lv = la + (size_t)4096 * 64; float* lg = lv + (size_t)4096 * 64;
    lw = hb; la = lw + (size_t)4096 * 64; lv = la + (size_t)4096 * 64; lg = lv + (size_t)4096 * 64;
    float* oscan = mix6;
    float* yin = mix6 + U;

    for (int chunk = 0; chunk < 5; ++chunk) {
        const int sample = chunk == 4;
        const int Mc = sample ? DB * DT : SEQ, T = sample ? DT : SEQ, nseq = sample ? DB : 1, b0 = sample ? 0 : chunk;
        const float* xin = sample ? x_sample : x_prompt + (size_t)chunk * SEQ * D;
        hipLaunchKernelGGL(copy_f32, dim3((Mc * D + 255) / 256), dim3(256), 0, stream, xin, xc, (size_t)Mc * D);
        for (int layer = 0; layer < 4; ++layer) {
            const int j = layer / 2;
            if (layer % 2 == 0) {
                gemm(stream, xc, D, w_qkv + (size_t)j * D * QKV, QKV, Mc, D, QKV, qkv, QKV, b_qkv + j * QKV, 0);
                const float* ck = cache_k + (size_t)j * DB * WIN * 256; const float* cv = cache_v + (size_t)j * DB * WIN * 256;
                hipLaunchKernelGGL(attn_naive, dim3(Mc * NH / 4), dim3(256), 0, stream, qkv, T, sample, ck, cv, sinks + j * NH, rel_bias, ao, Mc);
                float* ok = sample ? o_sk + (size_t)j * DB * WIN * 256 : o_pk + ((size_t)j * NB + b0) * WIN * 256;
                float* ov = sample ? o_sv + (size_t)j * DB * WIN * 256 : o_pv + ((size_t)j * NB + b0) * WIN * 256;
                hipLaunchKernelGGL(cache_out, dim3(nseq * WIN), dim3(256), 0, stream, qkv, T, sample, ck, D, ok, nseq);
                hipLaunchKernelGGL(cache_out, dim3(nseq * WIN), dim3(256), 0, stream, qkv, T, sample, cv, D + 256, ov, nseq);
                gemm(stream, ao, D, w_o + (size_t)j * D * D, D, Mc, D, D, hb, D, b_o + j * D, 0);
            } else {
                float* nshift = sample ? o_ss + (size_t)j * DB * D : o_ps + ((size_t)j * NB + b0) * D;
                hipLaunchKernelGGL(rwkv_mix, dim3(Mc), dim3(256), 0, stream, xc, T, sample ? state_shift + (size_t)j * DB * D : (const float*)nullptr, mix + (size_t)j * 6 * D, mix6, U, nshift);
                const float* xr = mix6; const float* xw = mix6 + U; const float* xk = mix6 + 2 * U; const float* xv = mix6 + 3 * U; const float* xa = mix6 + 4 * U; const float* xg = mix6 + 5 * U;
                const float* Wr = w_rkv + (size_t)(j * 3 + 0) * D * D; const float* Wk = w_rkv + (size_t)(j * 3 + 1) * D * D; const float* Wv = w_rkv + (size_t)(j * 3 + 2) * D * D;
                gemm(stream, xr, D, Wr, D, Mc, D, D, rr, D, nullptr, 0);
                gemm(stream, xk, D, Wk, D, Mc, D, D, kb, D, nullptr, 0);
                gemm(stream, xv, D, Wv, D, Mc, D, D, vb, D, nullptr, 0);
                gemm(stream, xw, D, w1 + (size_t)j * D * 64, 64, Mc, D, 64, lw, 64, nullptr, 1);
                gemm(stream, lw, 64, w2 + (size_t)j * 64 * D, D, Mc, 64, D, wl, D, nullptr, 0);
                gemm(stream, xa, D, a1 + (size_t)j * D * 64, 64, Mc, D, 64, la, 64, nullptr, 0);
                gemm(stream, la, 64, a2 + (size_t)j * 64 * D, D, Mc, 64, D, al, D, nullptr, 0);
                if (j > 0) {
                    gemm(stream, xv, D, v1, 32, Mc, D, 32, lv, 32, nullptr, 0);
                    gemm(stream, lv, 32, v2, D, Mc, 32, D, vl, D, nullptr, 0);
                }
                gemm(stream, xg, D, g1 + (size_t)j * D * 160, 160, Mc, D, 160, lg, 160, nullptr, 2);
                gemm(stream, lg, 160, g2 + (size_t)j * 160 * D, D, Mc, 160, D, gb, D, nullptr, 0);
                hipLaunchKernelGGL(rwkv_prep, dim3(Mc * 16 / 4), dim3(256), 0, stream, kb, vb, wl, al, vl, kkb, vfirst, j == 0 ? 1 : 0,
                                   w0 + j * D, a0 + j * D, v0, k_k + j * D, k_a + j * D, Mc);
                float* sout = sample ? o_sw + (size_t)j * DB * 16 * 4096 : o_pw + ((size_t)j * NB + b0) * 16 * 4096;
                hipLaunchKernelGGL(rwkv_scan, dim3(nseq * 16), dim3(256), 0, stream, rr, wl, kb, vb, kkb, al, T, sample ? state_wkv + (size_t)j * DB * 16 * 4096 : (const float*)nullptr, oscan, sout);
                hipLaunchKernelGGL(rwkv_post, dim3(Mc * 16 / 4), dim3(256), 0, stream, oscan, rr, kb, vb, gb, r_k + j * D, gn_w + j * D, gn_b + j * D, yin, Mc);
                gemm(stream, yin, D, rw_o + (size_t)j * D * D, D, Mc, D, D, hb, D, nullptr, 0);
            }
            hipLaunchKernelGGL(ln_res, dim3(Mc), dim3(256), 0, stream, xc, hb, ln_g + (layer * 2 + 0) * D, ln_b + (layer * 2 + 0) * D, xc);
            {
                dim3 grid(DFF / 64, Mc / 64);
                hipLaunchKernelGGL(gemm_naive<1>, grid, dim3(256), 0, stream, xc, D, w_gu + (size_t)layer * D * 2 * DFF, 2 * DFF, D, DFF, act, DFF, (const float*)nullptr, 0, DFF);
            }
            gemm(stream, act, DFF, w_down + (size_t)layer * DFF * D, D, Mc, DFF, D, hb, D, nullptr, 0);
            float* dst = (layer == 3) ? (sample ? o_ys : o_yp + (size_t)chunk * SEQ * D) : xc;
            hipLaunchKernelGGL(ln_res, dim3(Mc), dim3(256), 0, stream, xc, hb, ln_g + (layer * 2 + 1) * D, ln_b + (layer * 2 + 1) * D, dst);
        }
    }
}
```
